# Optimizing an MI355X kernel written in HIP

```python
import jax, jax.numpy as jnp
from jax import lax
import numpy as np

D_MODEL = 1024
BATCH = 4
SEQ = 8192
DEPTH = 1

HEAD_DIM = 64
A_Q_HEADS = 8
A_KV_HEADS = 2
A_HALF_WINDOW = 128
B_HEADS = 8
B_PATTERNS = ((128, 1), (512, 4), (2048, 16))
D_FF = 2816
ROPE_THETA = 10000.0
NORM_EPS = 1e-6
FFN_RES_WEIGHT = 0.5

A_Q_W = A_Q_HEADS * HEAD_DIM
A_KV_W = A_KV_HEADS * HEAD_DIM
B_W = B_HEADS * HEAD_DIM
IN_W = A_Q_W + 2 * A_KV_W + 3 * B_W
MIX_W = A_Q_W + B_W

kernel_name = "hybrid_window_gqa_dilated_macaron_encoder"


def rms_norm(x, g):
    xf = x.astype(jnp.float32)
    y = xf * lax.rsqrt(jnp.mean(xf * xf, axis=-1, keepdims=True) + NORM_EPS)
    return (y * g.astype(jnp.float32)).astype(x.dtype)


def swiglu(h, w_gate, w_up, w_down):
    return (jax.nn.silu(h @ w_gate) * (h @ w_up)) @ w_down


def rope_tables(positions):
    inv_freq = 1.0 / (ROPE_THETA ** (jnp.arange(0, HEAD_DIM, 2, dtype=jnp.float32) / HEAD_DIM))
    ang = positions.astype(jnp.float32)[..., None] * inv_freq
    return jnp.cos(ang)[:, :, None, :], jnp.sin(ang)[:, :, None, :]


def apply_rope(t, cos, sin):
    tf = t.astype(jnp.float32)
    t1, t2 = jnp.split(tf, 2, axis=-1)
    return jnp.concatenate([t1 * cos - t2 * sin, t2 * cos + t1 * sin], axis=-1).astype(t.dtype)


def banded_attention(q, k, v, half_window, sink=None):
    blk = half_window
    B, L, Hq, Dh = q.shape
    Hkv = k.shape[2]
    G = Hq // Hkv
    nb = -(-L // blk)
    Lp = nb * blk
    pad = Lp - L
    qb = jnp.pad(q, ((0, 0), (0, pad), (0, 0), (0, 0))).astype(jnp.float32).reshape(B, nb, blk, Hkv, G, Dh)
    kp = jnp.pad(k, ((0, 0), (blk, blk + pad), (0, 0), (0, 0))).astype(jnp.float32)
    vp = jnp.pad(v, ((0, 0), (blk, blk + pad), (0, 0), (0, 0))).astype(jnp.float32)
    kw = jnp.concatenate([kp[:, j * blk:j * blk + Lp].reshape(B, nb, blk, Hkv, Dh) for j in range(3)], axis=2)
    vw = jnp.concatenate([vp[:, j * blk:j * blk + Lp].reshape(B, nb, blk, Hkv, Dh) for j in range(3)], axis=2)
    qpos = jnp.arange(Lp).reshape(nb, blk)
    kpos = jnp.arange(nb)[:, None] * blk + jnp.arange(3 * blk)[None, :] - blk
    valid = (jnp.abs(qpos[:, :, None] - kpos[:, None, :]) <= half_window) & (kpos[:, None, :] >= 0) & (kpos[:, None, :] < L)
    s = jnp.einsum('bnqhgd,bnkhd->bnhgqk', qb, kw) * (Dh ** -0.5)
    s = jnp.where(valid[None, :, None, None], s, -jnp.inf)
    m = jnp.max(s, axis=-1)
    if sink is not None:
        sk = sink.astype(jnp.float32).reshape(Hkv, G)[None, None, :, :, None]
        m = jnp.maximum(m, sk)
    p = jnp.exp(s - m[..., None])
    den = jnp.sum(p, axis=-1)
    if sink is not None:
        den = den + jnp.exp(sk - m)
    o = jnp.einsum('bnhgqk,bnkhd->bnqhgd', p, vw) / jnp.transpose(den, (0, 1, 4, 2, 3))[..., None]
    lse = jnp.transpose(m + jnp.log(den), (0, 1, 4, 2, 3)).reshape(B, Lp, Hq)[:, :L]
    return o.reshape(B, Lp, Hq, Dh)[:, :L], lse


def dilated_window_attention(q, k, v, window, dilation):
    B, S, H, Dh = q.shape
    msub = S // dilation

    def to_sub(t):
        return t.reshape(B, msub, dilation, H, Dh).transpose(0, 2, 1, 3, 4).reshape(B * dilation, msub, H, Dh)

    o, lse = banded_attention(to_sub(q), to_sub(k), to_sub(v), window // (2 * dilation))
    o = o.reshape(B, dilation, msub, H, Dh).transpose(0, 2, 1, 3, 4).reshape(B, S, H, Dh)
    lse = lse.reshape(B, dilation, msub, H).transpose(0, 2, 1, 3).reshape(B, S, H)
    return o, lse


def mixer(h, w_in, a_sink, w_out, cos, sin):
    B, S, _ = h.shape
    proj = h @ w_in
    cuts = np.cumsum([A_Q_W, A_KV_W, A_KV_W, B_W, B_W]).tolist()
    aq, ak, av, bq, bk, bv = jnp.split(proj, cuts, axis=-1)
    aq = apply_rope(aq.reshape(B, S, A_Q_HEADS, HEAD_DIM), cos, sin)
    ak = apply_rope(ak.reshape(B, S, A_KV_HEADS, HEAD_DIM), cos, sin)
    av = av.reshape(B, S, A_KV_HEADS, HEAD_DIM)
    bq = apply_rope(bq.reshape(B, S, B_HEADS, HEAD_DIM), cos, sin)
    bk = apply_rope(bk.reshape(B, S, B_HEADS, HEAD_DIM), cos, sin)
    bv = bv.reshape(B, S, B_HEADS, HEAD_DIM)
    a_out, _ = banded_attention(aq, ak, av, A_HALF_WINDOW, sink=a_sink)
    outs, lses = [], []
    for w, d in B_PATTERNS:
        o, l = dilated_window_attention(bq, bk, bv, w, d)
        outs.append(o)
        lses.append(l)
    wts = jax.nn.softmax(jnp.stack(lses, axis=0), axis=0)
    b_out = jnp.sum(wts[..., None] * jnp.stack(outs, axis=0), axis=0)
    cat = jnp.concatenate([a_out.reshape(B, S, A_Q_W), b_out.reshape(B, S, B_W)], axis=-1).astype(h.dtype)
    return cat @ w_out


def setup_inputs(seed: int = 0) -> dict:
    key = jax.random.key(seed)
    ks = jax.random.split(key, 16)
    f32 = jnp.float32
    nrm = lambda k, shape, scale: jax.random.normal(k, shape, f32) * scale
    gain = lambda k: 1.0 + 0.02 * jax.random.normal(k, (DEPTH, D_MODEL), f32)
    x = jax.random.normal(ks[0], (BATCH, SEQ, D_MODEL), f32)
    offsets = jax.random.randint(ks[1], (BATCH, 1), 0, 4096, dtype=jnp.int32)
    positions = (jnp.arange(SEQ, dtype=jnp.int32)[None, :] + offsets).astype(jnp.int32)
    return {
        "x": x,
        "positions": positions,
        "norm_ffn1": gain(ks[2]),
        "w_gate1": nrm(ks[3], (DEPTH, D_MODEL, D_FF), D_MODEL ** -0.5),
        "w_up1": nrm(ks[4], (DEPTH, D_MODEL, D_FF), D_MODEL ** -0.5),
        "w_down1": nrm(ks[5], (DEPTH, D_FF, D_MODEL), D_FF ** -0.5),
        "norm_mix": gain(ks[6]),
        "w_in": nrm(ks[7], (DEPTH, D_MODEL, IN_W), D_MODEL ** -0.5),
        "a_sink": nrm(ks[8], (DEPTH, A_Q_HEADS), 0.5),
        "w_out": nrm(ks[9], (DEPTH, MIX_W, D_MODEL), MIX_W ** -0.5),
        "norm_ffn2": gain(ks[10]),
        "w_gate2": nrm(ks[11], (DEPTH, D_MODEL, D_FF), D_MODEL ** -0.5),
        "w_up2": nrm(ks[12], (DEPTH, D_MODEL, D_FF), D_MODEL ** -0.5),
        "w_down2": nrm(ks[13], (DEPTH, D_FF, D_MODEL), D_FF ** -0.5),
        "norm_final": 1.0 + 0.02 * jax.random.normal(ks[14], (D_MODEL,), f32),
    }


def reference(x, positions, norm_ffn1, w_gate1, w_up1, w_down1, norm_mix, w_in, a_sink, w_out,
              norm_ffn2, w_gate2, w_up2, w_down2, norm_final):
    cos, sin = rope_tables(positions)
    for l in range(DEPTH):
        x = x + FFN_RES_WEIGHT * swiglu(rms_norm(x, norm_ffn1[l]), w_gate1[l], w_up1[l], w_down1[l])
        x = x + mixer(rms_norm(x, norm_mix[l]), w_in[l], a_sink[l], w_out[l], cos, sin)
        x = x + FFN_RES_WEIGHT * swiglu(rms_norm(x, norm_ffn2[l]), w_gate2[l], w_up2[l], w_down2[l])
    return rms_norm(x, norm_final)
```

```cpp
#include <hip/hip_runtime.h>
#include <cstdio>
#include <cstdint>
#include <cmath>

namespace nv {
constexpr int D_MODEL = 1024, BATCH = 4, SEQ = 8192, HD = 64, D_FF = 2816, IN_W = 2304;
constexpr float EPS = 1e-6f;
struct RopeTab { float inv_freq[32]; };

__global__ __launch_bounds__(256) void rmsnorm(const float* x, const float* g, float* out) {
    __shared__ float red[4];
    const size_t row = blockIdx.x; const int t = threadIdx.x;
    const float4 v = *(const float4*)(x + row * D_MODEL + t * 4);
    float s = v.x * v.x + v.y * v.y + v.z * v.z + v.w * v.w;
    for (int o = 32; o > 0; o >>= 1) s += __shfl_xor(s, o);
    if ((t & 63) == 0) red[t >> 6] = s;
    __syncthreads();
    const float tot = red[0] + red[1] + red[2] + red[3];
    const float r = 1.0f / sqrtf(tot * (1.0f / D_MODEL) + EPS);
    const float4 gg = *(const float4*)(g + t * 4);
    float4 o; o.x = v.x * r * gg.x; o.y = v.y * r * gg.y; o.z = v.z * r * gg.z; o.w = v.w * r * gg.w;
    *(float4*)(out + row * D_MODEL + t * 4) = o;
}

template <int MODE>
__global__ __launch_bounds__(256) void gemm(const float* A, const float* W, const float* W2, float* C, const float* R, int M, int N, int K, float scale) {
    __shared__ float As[16][68];
    __shared__ float Bs[16][64];
    __shared__ float B2s[16][64];
    const int t = threadIdx.x, tx = t & 15, ty = t >> 4;
    const int m0 = blockIdx.y * 64, n0 = blockIdx.x * 64;
    float acc[4][4], acc2[4][4];
#pragma unroll
    for (int i = 0; i < 4; ++i)
#pragma unroll
        for (int j = 0; j < 4; ++j) { acc[i][j] = 0.f; acc2[i][j] = 0.f; }
    for (int k0 = 0; k0 < K; k0 += 16) {
        const float4 a = *(const float4*)(A + (size_t)(m0 + (t >> 2)) * K + k0 + (t & 3) * 4);
        As[(t & 3) * 4 + 0][t >> 2] = a.x; As[(t & 3) * 4 + 1][t >> 2] = a.y; As[(t & 3) * 4 + 2][t >> 2] = a.z; As[(t & 3) * 4 + 3][t >> 2] = a.w;
        const float4 b = *(const float4*)(W + (size_t)(k0 + (t >> 4)) * N + n0 + (t & 15) * 4);
        *(float4*)&Bs[t >> 4][(t & 15) * 4] = b;
        if (MODE == 1) { const float4 b2 = *(const float4*)(W2 + (size_t)(k0 + (t >> 4)) * N + n0 + (t & 15) * 4); *(float4*)&B2s[t >> 4][(t & 15) * 4] = b2; }
        __syncthreads();
#pragma unroll
        for (int kk = 0; kk < 16; ++kk) {
            const float4 av = *(const float4*)&As[kk][ty * 4];
            const float4 bv = *(const float4*)&Bs[kk][tx * 4];
            const float af[4] = {av.x, av.y, av.z, av.w}; const float bf[4] = {bv.x, bv.y, bv.z, bv.w};
#pragma unroll
            for (int i = 0; i < 4; ++i)
#pragma unroll
                for (int j = 0; j < 4; ++j) acc[i][j] = fmaf(af[i], bf[j], acc[i][j]);
            if (MODE == 1) {
                const float4 cv = *(const float4*)&B2s[kk][tx * 4]; const float cf[4] = {cv.x, cv.y, cv.z, cv.w};
#pragma unroll
                for (int i = 0; i < 4; ++i)
#pragma unroll
                    for (int j = 0; j < 4; ++j) acc2[i][j] = fmaf(af[i], cf[j], acc2[i][j]);
            }
        }
        __syncthreads();
    }
#pragma unroll
    for (int i = 0; i < 4; ++i) {
        const size_t off = (size_t)(m0 + ty * 4 + i) * N + n0 + tx * 4;
        float4 o;
        if (MODE == 0) {
            float4 r = {0.f, 0.f, 0.f, 0.f}; if (R) r = *(const float4*)(R + off);
            o.x = r.x + scale * acc[i][0]; o.y = r.y + scale * acc[i][1]; o.z = r.z + scale * acc[i][2]; o.w = r.w + scale * acc[i][3];
        } else {
            float h[4];
#pragma unroll
            for (int j = 0; j < 4; ++j) { const float gte = acc[i][j]; h[j] = gte / (1.0f + expf(-gte)) * acc2[i][j]; }
            o.x = h[0]; o.y = h[1]; o.z = h[2]; o.w = h[3];
        }
        *(float4*)(C + off) = o;
    }
}

__global__ __launch_bounds__(256) void rope(float* P, const int* pos, RopeTab tab) {
    const int id = blockIdx.x * 256 + threadIdx.x;
    const int i = id & 31, slot = (id >> 5) % 26, t = id / (32 * 26);
    if (t >= SEQ) return;
    int col;
    if (slot < 8) col = slot * 64; else if (slot < 10) col = 512 + (slot - 8) * 64; else if (slot < 18) col = 768 + (slot - 10) * 64; else col = 1280 + (slot - 18) * 64;
    const float ang = (float)pos[t] * tab.inv_freq[i];
    float sn, cs; sincosf(ang, &sn, &cs);
    float* p = P + (size_t)t * IN_W + col + i;
    const float t1 = p[0], t2 = p[32];
    p[0] = t1 * cs - t2 * sn; p[32] = t2 * cs + t1 * sn;
}

__global__ __launch_bounds__(256) void attn(const float* P, const float* sink, float* cat) {
    const int id = blockIdx.x * 256 + threadIdx.x; const int hh = id / SEQ, t = id % SEQ;
    float q[64], acc[64];
    if (hh < 8) {
        const float* qp = P + (size_t)t * IN_W + hh * 64;
#pragma unroll
        for (int c = 0; c < 64; ++c) { q[c] = qp[c] * 0.125f; acc[c] = 0.f; }
        const int kvh = hh >> 2; float m = sink[hh], l = 1.0f;
        const int j0 = t - 128 < 0 ? 0 : t - 128, j1 = t + 128 > SEQ - 1 ? SEQ - 1 : t + 128;
        for (int j = j0; j <= j1; ++j) {
            const float* kp = P + (size_t)j * IN_W + 512 + kvh * 64; const float* vp = P + (size_t)j * IN_W + 640 + kvh * 64;
            float s = 0.f;
#pragma unroll
            for (int c = 0; c < 64; ++c) s = fmaf(q[c], kp[c], s);
            const float mn = fmaxf(m, s), a = expf(m - mn), p = expf(s - mn);
            l = l * a + p; m = mn;
#pragma unroll
            for (int c = 0; c < 64; ++c) acc[c] = acc[c] * a + p * vp[c];
        }
        const float il = 1.0f / l; float* op = cat + (size_t)t * D_MODEL + hh * 64;
#pragma unroll
        for (int c = 0; c < 64; ++c) op[c] = acc[c] * il;
    } else {
        const int hb = hh - 8; float outr[64];
        const float* qp = P + (size_t)t * IN_W + 768 + hb * 64;
#pragma unroll
        for (int c = 0; c < 64; ++c) { q[c] = qp[c] * 0.125f; outr[c] = 0.f; }
        float Rl = -INFINITY;
        for (int pt = 0; pt < 3; ++pt) {
            const int dil = pt == 0 ? 1 : (pt == 1 ? 4 : 16);
            float m = -INFINITY, l = 0.f;
#pragma unroll
            for (int c = 0; c < 64; ++c) acc[c] = 0.f;
            for (int n = -64; n <= 64; ++n) {
                const int j = t + n * dil; if (j < 0 || j >= SEQ) continue;
                const float* kp = P + (size_t)j * IN_W + 1280 + hb * 64; const float* vp = P + (size_t)j * IN_W + 1792 + hb * 64;
                float s = 0.f;
#pragma unroll
                for (int c = 0; c < 64; ++c) s = fmaf(q[c], kp[c], s);
                const float mn = fmaxf(m, s), a = expf(m - mn), p = expf(s - mn);
                l = l * a + p; m = mn;
#pragma unroll
                for (int c = 0; c < 64; ++c) acc[c] = acc[c] * a + p * vp[c];
            }
            const float lse = m + logf(l);
            const float Rn = fmaxf(Rl, lse) + logf(expf(Rl - fmaxf(Rl, lse)) + expf(lse - fmaxf(Rl, lse)));
            const float wa = expf(Rl - Rn), wb = expf(lse - Rn) / l;
#pragma unroll
            for (int c = 0; c < 64; ++c) outr[c] = outr[c] * wa + acc[c] * wb;
            Rl = Rn;
        }
        float* op = cat + (size_t)t * D_MODEL + 512 + hb * 64;
#pragma unroll
        for (int c = 0; c < 64; ++c) op[c] = outr[c];
    }
}

static void forward(void* const* d_in, float* out, unsigned char* ws, hipStream_t stream) {
    const float* x = (const float*)d_in[0]; const int* pos = (const int*)d_in[1];
    const float* g1 = (const float*)d_in[2]; const float* wg1 = (const float*)d_in[3]; const float* wu1 = (const float*)d_in[4]; const float* wd1 = (const float*)d_in[5];
    const float* gm = (const float*)d_in[6]; const float* win = (const float*)d_in[7]; const float* sink = (const float*)d_in[8]; const float* wout = (const float*)d_in[9];
    const float* g3 = (const float*)d_in[10]; const float* wg2 = (const float*)d_in[11]; const float* wu2 = (const float*)d_in[12]; const float* wd2 = (const float*)d_in[13];
    const float* gf = (const float*)d_in[14];
    float* hbuf = (float*)ws;
    float* Hbuf = (float*)(ws + (size_t)64 * 1048576);
    float* Pbuf = (float*)(ws + (size_t)192 * 1048576);
    float* cbuf = (float*)(ws + (size_t)320 * 1048576);
    RopeTab tab;
    for (int k = 0; k < 32; ++k) { const float e = (float)k / 32.0f; const float p = (float)pow(10000.0, (double)e); tab.inv_freq[k] = 1.0f / p; }
    for (int b = 0; b < BATCH; ++b) {
        const float* xb = x + (size_t)b * SEQ * D_MODEL; float* ob = out + (size_t)b * SEQ * D_MODEL; const int* pb = pos + (size_t)b * SEQ;
        rmsnorm<<<SEQ, 256, 0, stream>>>(xb, g1, hbuf);
        gemm<1><<<dim3(D_FF / 64, SEQ / 64), 256, 0, stream>>>(hbuf, wg1, wu1, Hbuf, nullptr, SEQ, D_FF, D_MODEL, 1.f);
        gemm<0><<<dim3(D_MODEL / 64, SEQ / 64), 256, 0, stream>>>(Hbuf, wd1, nullptr, ob, xb, SEQ, D_MODEL, D_FF, 0.5f);
        rmsnorm<<<SEQ, 256, 0, stream>>>(ob, gm, hbuf);
        gemm<0><<<dim3(IN_W / 64, SEQ / 64), 256, 0, stream>>>(hbuf, win, nullptr, Pbuf, nullptr, SEQ, IN_W, D_MODEL, 1.f);
        rope<<<(SEQ * 26 * 32) / 256, 256, 0, stream>>>(Pbuf, pb, tab);
        attn<<<(SEQ * 16) / 256, 256, 0, stream>>>(Pbuf, sink, cbuf);
        gemm<0><<<dim3(D_MODEL / 64, SEQ / 64), 256, 0, stream>>>(cbuf, wout, nullptr, ob, ob, SEQ, D_MODEL, D_MODEL, 1.f);
        rmsnorm<<<SEQ, 256, 0, stream>>>(ob, g3, hbuf);
        gemm<1><<<dim3(D_FF / 64, SEQ / 64), 256, 0, stream>>>(hbuf, wg2, wu2, Hbuf, nullptr, SEQ, D_FF, D_MODEL, 1.f);
        gemm<0><<<dim3(D_MODEL / 64, SEQ / 64), 256, 0, stream>>>(Hbuf, wd2, nullptr, ob, ob, SEQ, D_MODEL, D_FF, 0.5f);
        rmsnorm<<<SEQ, 256, 0, stream>>>(ob, gf, ob);
    }
}
}

extern "C" void kernel_launch(void* const* d_in, const int* in_sizes, int n_in, void* d_out, int out_size, void* d_ws, size_t ws_size, hipStream_t stream) {
    if (n_in != 15 || out_size != nv::BATCH * nv::SEQ * nv::D_MODEL || ws_size < (size_t)400 * 1048576) { fprintf(stderr, "kernel_launch: unexpected shapes\n"); return; }
    nv::forward(d_in, (float*)d_out, (unsigned char*)d_ws, stream);
}
```

```cpp
#include <hip/hip_runtime.h>
#include <cstdio>
#include <cstdint>
#include <cmath>
namespace pg8 {
#define PG8_LAS __attribute__((address_space(3)))
typedef unsigned short bf16_t;
typedef short bf16x8 __attribute__((ext_vector_type(8)));
typedef float f32x4 __attribute__((ext_vector_type(4)));
typedef unsigned u32x4 __attribute__((ext_vector_type(4)));
constexpr int BM = 256, BK = 64, HALF = 128, HTB = HALF * BK * 2  , STAGE_BYTES = 8 * HTB, NXCD = 8, WGM = 8;

__host__ __device__ __forceinline__ int lds_byte(int r, int c) { const int st = (r >> 4) * 2 + (c >> 5), rr = r & 15, cc = c & 31, ob = rr * 64 + cc * 2; return st * 1024 + (ob ^ (((ob >> 9) & 1) << 5)); }
__host__ __device__ __forceinline__ void stage_rc(int b, int& R, int& C) { const int st = b / 1024, sb = b % 1024, swz = sb ^ (((sb >> 9) & 1) << 5); R = (st >> 1) * 16 + swz / 64; C = (st & 1) * 32 + (swz % 64) / 2; }
__host__ __device__ __forceinline__ int perm32(int rho) { const int n = rho >> 4, i = rho & 15; return 8 * (i >> 2) + 4 * n + (i & 3); }

struct Unit { int pm, pn; };
struct Gemm { const bf16_t* A; const bf16_t* Bt; int M, N, K; };

struct StaticOrder {
    int nM, nN, nwg, G, c;
    __host__ __device__ void init(int M, int N, int G_, int c_) { nM = M / BM; nN = N / BM; nwg = nM * nN; G = G_; c = c_; }
    __host__ __device__ bool next(int i, Unit& u) const {
        const long L = (long)i * G + c; if (L >= nwg) return false;
        int wgid = (int)L; { const int q = nwg / NXCD, r = nwg % NXCD, xcd = wgid % NXCD, off = wgid / NXCD; wgid = (xcd < r ? xcd * (q + 1) : r * (q + 1) + (xcd - r) * q) + off; }
        const int nig = WGM * nN, gid = wgid / nig, fm = gid * WGM, gsz = (nM - fm) < WGM ? (nM - fm) : WGM;
        u.pm = fm + ((wgid % nig) % gsz); u.pn = (wgid % nig) / gsz; return true;
    }
    __device__ __forceinline__ void a_ready(const Unit&) const {}
    __device__ __forceinline__ void done(const Unit&) const {}
};

__device__ __forceinline__ unsigned cvt_pk_bf16(float lo, float hi) { unsigned r; asm volatile("v_cvt_pk_bf16_f32 %0, %1, %2" : "=v"(r) : "v"(lo), "v"(hi)); return r; }
__device__ __forceinline__ float row_rstd(const float* ssq, int row, int fq) {
    const f32x4 v = *(const f32x4*)(ssq + (size_t)row * 16 + 4 * fq);
    float s = (v[0] + v[1]) + (v[2] + v[3]);
    s += __shfl_xor(s, 16); s += __shfl_xor(s, 32);
    return 1.0f / sqrtf(s * (1.0f / 1024.0f) + 1e-6f);
}
struct EpiSwiglu {
    static constexpr bool PERM = true, AFTER_DRAIN = false;
    bf16_t* H; const float* ssq; int ldh;
    __device__ __forceinline__ void operator()(const f32x4 (&acc)[2][2][4][2], const Unit& u, int wr, int wc, int fr, int fq) const {
        const int row0 = u.pm * BM + wr * 64 + fr, col0 = u.pn * HALF + wc * 32 + 8 * fq;
#pragma unroll
        for (int ai = 0; ai < 2; ++ai)
#pragma unroll
            for (int m = 0; m < 4; ++m) {
                const int row = row0 + ai * HALF + m * 16;
                const float rs = row_rstd(ssq, row, fq);
                float h[8];
#pragma unroll
                for (int n = 0; n < 2; ++n)
#pragma unroll
                    for (int e = 0; e < 4; ++e) {
                        const float g = acc[ai][0][m][n][e] * rs, up = acc[ai][1][m][n][e] * rs;
                        const float ex = __builtin_amdgcn_exp2f(g * -1.4426950408889634f);
                        h[n * 4 + e] = (g * up) * __builtin_amdgcn_rcpf(1.0f + ex);
                    }
                u32x4 w; w.x = cvt_pk_bf16(h[0], h[1]); w.y = cvt_pk_bf16(h[2], h[3]); w.z = cvt_pk_bf16(h[4], h[5]); w.w = cvt_pk_bf16(h[6], h[7]);
                *(u32x4*)(H + (size_t)row * ldh + col0) = w;
            }
    }
};
template <bool WRITE_BF16, bool WRITE_SSQ> struct EpiRes {
    static constexpr bool PERM = true, AFTER_DRAIN = false;
    const float* resid; float* out; bf16_t* xb; float* ssq; float scale;
    __device__ __forceinline__ void operator()(const f32x4 (&acc)[2][2][4][2], const Unit& u, int wr, int wc, int fr, int fq) const {
        const int row0 = u.pm * BM + wr * 64 + fr, colb = u.pn * BM + wc * 32 + 8 * fq;
#pragma unroll
        for (int ai = 0; ai < 2; ++ai)
#pragma unroll
            for (int m = 0; m < 4; ++m) {
                const int row = row0 + ai * HALF + m * 16; float sq = 0.f;
#pragma unroll
                for (int bj = 0; bj < 2; ++bj) {
                    const size_t off = (size_t)row * 1024 + colb + bj * HALF;
                    const f32x4 r0 = *(const f32x4*)(resid + off), r1 = *(const f32x4*)(resid + off + 4);
                    const f32x4 o0 = r0 + acc[ai][bj][m][0] * scale, o1 = r1 + acc[ai][bj][m][1] * scale;
                    *(f32x4*)(out + off) = o0; *(f32x4*)(out + off + 4) = o1;
                    if (WRITE_BF16) { u32x4 w; w.x = cvt_pk_bf16(o0[0], o0[1]); w.y = cvt_pk_bf16(o0[2], o0[3]); w.z = cvt_pk_bf16(o1[0], o1[1]); w.w = cvt_pk_bf16(o1[2], o1[3]); *(u32x4*)(xb + off) = w; }
                    if (WRITE_SSQ) sq += ((o0[0] * o0[0] + o0[1] * o0[1]) + (o0[2] * o0[2] + o0[3] * o0[3])) + ((o1[0] * o1[0] + o1[1] * o1[1]) + (o1[2] * o1[2] + o1[3] * o1[3]));
                }
                if (WRITE_SSQ) { sq += __shfl_xor(sq, 16); sq += __shfl_xor(sq, 32); if (fq == 0) ssq[(size_t)row * 16 + 4 * u.pn + wc] = sq; }
            }
    }
};
struct EpiQkv {
    static constexpr bool PERM = true, AFTER_DRAIN = false;
    bf16_t* PJ; const float* ssq; const float* cosT; const float* sinT; float qscale; int ldp;
    __device__ __forceinline__ void operator()(const f32x4 (&acc)[2][2][4][2], const Unit& u, int wr, int wc, int fr, int fq) const {
        const int row0 = u.pm * BM + wr * 64 + fr, hc = u.pn * BM + wc * 64;
        const bool rope = (hc < 640) || (hc >= 768 && hc < 1792);
        const bool isq = (hc < 512) || (hc >= 768 && hc < 1280);
        const float sc = isq ? qscale : 1.0f;
#pragma unroll
        for (int ai = 0; ai < 2; ++ai)
#pragma unroll
            for (int m = 0; m < 4; ++m) {
                const int row = row0 + ai * HALF + m * 16;
                const float rs = row_rstd(ssq, row, fq) * sc;
                f32x4 o1[2], o2[2];
#pragma unroll
                for (int n = 0; n < 2; ++n) {
                    const f32x4 t1 = acc[ai][0][m][n] * rs, t2 = acc[ai][1][m][n] * rs;
                    if (rope) {
                        const f32x4 c = *(const f32x4*)(cosT + (size_t)row * 32 + 8 * fq + 4 * n), s = *(const f32x4*)(sinT + (size_t)row * 32 + 8 * fq + 4 * n);
                        o1[n] = t1 * c - t2 * s; o2[n] = t2 * c + t1 * s;
                    } else { o1[n] = t1; o2[n] = t2; }
                }
                u32x4 w1, w2;
                w1.x = cvt_pk_bf16(o1[0][0], o1[0][1]); w1.y = cvt_pk_bf16(o1[0][2], o1[0][3]); w1.z = cvt_pk_bf16(o1[1][0], o1[1][1]); w1.w = cvt_pk_bf16(o1[1][2], o1[1][3]);
                w2.x = cvt_pk_bf16(o2[0][0], o2[0][1]); w2.y = cvt_pk_bf16(o2[0][2], o2[0][3]); w2.z = cvt_pk_bf16(o2[1][0], o2[1][1]); w2.w = cvt_pk_bf16(o2[1][2], o2[1][3]);
                bf16_t* p = PJ + (size_t)row * ldp + hc + 8 * fq;
                *(u32x4*)p = w1; *(u32x4*)(p + 32) = w2;
            }
    }
};

template <class Epi, class Sched, bool ALIGN_EPI = false, bool SP2 = false>
__device__ __forceinline__ void gemm_phase(PG8_LAS unsigned char* lds, const Gemm g, const Sched& S, const Epi& E) {
    int tid_ = threadIdx.x; asm volatile("" : "+v"(tid_));
    const int tid = tid_, wid = __builtin_amdgcn_readfirstlane(tid >> 6), lane = tid & 63, wr = wid >> 2, wc = wid & 3, fr = lane & 15, fq = lane >> 4;
    const int K = g.K, nt = K / BK;
    unsigned voffA[2], voffB[2];
#pragma unroll
    for (int i = 0; i < 2; ++i) { int R, C; stage_rc(tid * 16 + i * 8192, R, C); const int Rb = Epi::PERM ? ((R & ~31) + perm32(R & 31)) : R;
        voffA[i] = (unsigned)(R * K + C) * 2u; voffB[i] = (unsigned)(Rb * K + C) * 2u; }
    const size_t kstep = (size_t)(BK * 2);
    const size_t hstep = (size_t)HALF * K * 2;
    const size_t tstep = 2 * hstep;
    const unsigned ldsw = (unsigned)wid * 1024u;
    const int aoff = lds_byte(wr * 64 + fr, fq * 8), boff = lds_byte(wc * 32 + fr, fq * 8);
#define PG8_SA(b, h) (((b) * 2 + (h)) * HTB)
#define PG8_SB(b, h) ((4 + (b) * 2 + (h)) * HTB)
#define PG8_STAGE(bufoff, gbase, voff) do { _Pragma("unroll") for (int _i = 0; _i < 2; ++_i) \
        __builtin_amdgcn_global_load_lds((const unsigned*)((const char*)(gbase) + (voff)[_i]), (PG8_LAS unsigned*)(lds + (bufoff) + ldsw + _i * 8192), 16, 0, 0); } while (0)
#define PG8_LDA(dst, b, h) do { _Pragma("unroll") for (int m = 0; m < 4; ++m) _Pragma("unroll") for (int k = 0; k < 2; ++k) dst[m][k] = *(const PG8_LAS bf16x8*)(lds + PG8_SA(b, h) + aoff + m * 2048 + k * 1024); } while (0)
#define PG8_LDB(dst, b, h) do { _Pragma("unroll") for (int n = 0; n < 2; ++n) _Pragma("unroll") for (int k = 0; k < 2; ++k) dst[n][k] = *(const PG8_LAS bf16x8*)(lds + PG8_SB(b, h) + boff + n * 2048 + k * 1024); } while (0)
#define PG8_MMA(ai, bj, At, Bt) do { __builtin_amdgcn_s_setprio(1); _Pragma("unroll") for (int m = 0; m < 4; ++m) _Pragma("unroll") for (int n = 0; n < 2; ++n) _Pragma("unroll") for (int k = 0; k < 2; ++k) \
        acc[ai][bj][m][n] = __builtin_amdgcn_mfma_f32_16x16x32_bf16(Bt[n][k], At[m][k], acc[ai][bj][m][n], 0, 0, 0); __builtin_amdgcn_s_setprio(0); } while (0)
#define PG8_WAIT_V(n) asm volatile("s_waitcnt vmcnt(" #n ")" ::: "memory")
#define PG8_WAIT_L(n) asm volatile("s_waitcnt lgkmcnt(" #n ")" ::: "memory")
#define PG8_BAR __builtin_amdgcn_s_barrier()
#define PG8_SCHED __builtin_amdgcn_sched_barrier(0)
    Unit cur, nxt; int ui = 0;
    if (!S.next(0, cur)) return;
    f32x4 acc[2][2][4][2];
#pragma unroll
    for (int a = 0; a < 2; ++a)
#pragma unroll
        for (int b = 0; b < 2; ++b)
#pragma unroll
            for (int m = 0; m < 4; ++m)
#pragma unroll
                for (int n = 0; n < 2; ++n) acc[a][b][m][n] = (f32x4){0.f, 0.f, 0.f, 0.f};
    bf16x8 At[4][2], B0[2][2], B1[2][2];
    const char* cA = (const char*)g.A + (size_t)cur.pm * tstep; const char* cB = (const char*)g.Bt + (size_t)cur.pn * tstep;
    S.a_ready(cur);
    if constexpr (SP2) {
        PG8_STAGE(PG8_SB(0, 0), cB, voffB); PG8_STAGE(PG8_SB(0, 1), cB + hstep, voffB); PG8_STAGE(PG8_SA(0, 0), cA, voffA); PG8_STAGE(PG8_SA(0, 1), cA + hstep, voffA);
        if (wr == 1) PG8_BAR;
        PG8_WAIT_V(2); PG8_BAR;
        PG8_STAGE(PG8_SB(1, 0), cB + kstep, voffB); PG8_STAGE(PG8_SA(1, 0), cA + kstep, voffA); PG8_STAGE(PG8_SB(1, 1), cB + hstep + kstep, voffB);
        PG8_WAIT_V(6); PG8_BAR;
    } else {
        PG8_STAGE(PG8_SB(0, 0), cB, voffB); PG8_STAGE(PG8_SA(0, 0), cA, voffA); PG8_STAGE(PG8_SB(0, 1), cB + hstep, voffB); PG8_STAGE(PG8_SA(0, 1), cA + hstep, voffA);
        if (wr == 1) PG8_BAR;
        PG8_WAIT_V(4); PG8_BAR;
        PG8_STAGE(PG8_SB(1, 0), cB + kstep, voffB); PG8_STAGE(PG8_SA(1, 0), cA + kstep, voffA); PG8_STAGE(PG8_SB(1, 1), cB + hstep + kstep, voffB);
        PG8_WAIT_V(6); PG8_BAR;
    }
    for (;;) {
        const bool has_next = S.next(ui + 1, nxt);
        const char* nA = has_next ? (const char*)g.A + (size_t)nxt.pm * tstep : cA; const char* nB = has_next ? (const char*)g.Bt + (size_t)nxt.pn * tstep : cB;
        for (int t = 0; t < nt; t += 2) {
            const bool last = (t == nt - 2);
            const char* a1 = cA + (size_t)(t + 1) * kstep;
            const char* a2 = last ? nA : cA + (size_t)(t + 2) * kstep; const char* b2 = last ? nB : cB + (size_t)(t + 2) * kstep;
            const char* a3 = a2 + kstep; const char* b3 = b2 + kstep;
            if (last && has_next) S.a_ready(nxt);
            if constexpr (SP2) {
            PG8_LDB(B0, 0, 0); PG8_LDB(B1, 0, 1); PG8_SCHED; PG8_LDA(At, 0, 0); PG8_STAGE(PG8_SA(1, 1), a1 + hstep, voffA);
            PG8_WAIT_V(8); PG8_WAIT_L(0); PG8_BAR; PG8_MMA(0, 0, At, B0); PG8_MMA(0, 1, At, B1); PG8_BAR; PG8_SCHED;
            PG8_LDA(At, 0, 1); PG8_STAGE(PG8_SB(0, 0), b2, voffB); PG8_STAGE(PG8_SB(0, 1), b2 + hstep, voffB); PG8_STAGE(PG8_SA(0, 0), a2, voffA);
            PG8_WAIT_V(8); PG8_WAIT_L(0); PG8_BAR; PG8_MMA(1, 0, At, B0); PG8_MMA(1, 1, At, B1); PG8_BAR; PG8_SCHED;
            PG8_LDB(B0, 1, 0); PG8_LDB(B1, 1, 1); PG8_SCHED; PG8_LDA(At, 1, 0); PG8_STAGE(PG8_SA(0, 1), a2 + hstep, voffA);
            PG8_WAIT_V(8); PG8_WAIT_L(0); PG8_BAR; PG8_MMA(0, 0, At, B0); PG8_MMA(0, 1, At, B1); PG8_BAR; PG8_SCHED;
            PG8_LDA(At, 1, 1); PG8_STAGE(PG8_SB(1, 0), b3, voffB); PG8_STAGE(PG8_SB(1, 1), b3 + hstep, voffB); PG8_STAGE(PG8_SA(1, 0), a3, voffA);
            PG8_WAIT_V(8); PG8_WAIT_L(0); PG8_BAR; PG8_MMA(1, 0, At, B0); PG8_MMA(1, 1, At, B1); PG8_BAR; PG8_SCHED;
            } else {
            PG8_LDB(B0, 0, 0); PG8_SCHED; PG8_LDA(At, 0, 0); PG8_STAGE(PG8_SA(1, 1), a1 + hstep, voffA);
            PG8_WAIT_L(8); PG8_BAR; PG8_WAIT_L(0); PG8_MMA(0, 0, At, B0); PG8_BAR; PG8_SCHED;
            PG8_LDB(B1, 0, 1); PG8_STAGE(PG8_SB(0, 0), b2, voffB);
            PG8_BAR; PG8_WAIT_L(0); PG8_MMA(0, 1, At, B1); PG8_BAR;
            PG8_LDA(At, 0, 1); PG8_STAGE(PG8_SA(0, 0), a2, voffA);
            PG8_BAR; PG8_WAIT_L(0); PG8_MMA(1, 0, At, B0); PG8_BAR; PG8_SCHED;
            PG8_STAGE(PG8_SB(0, 1), b2 + hstep, voffB);
            PG8_WAIT_V(6); PG8_BAR; PG8_MMA(1, 1, At, B1); PG8_BAR;
            PG8_LDB(B0, 1, 0); PG8_SCHED; PG8_LDA(At, 1, 0); PG8_STAGE(PG8_SA(0, 1), a2 + hstep, voffA);
            PG8_WAIT_L(8); PG8_BAR; PG8_WAIT_L(0); PG8_MMA(0, 0, At, B0); PG8_BAR; PG8_SCHED;
            PG8_LDB(B1, 1, 1); PG8_STAGE(PG8_SB(1, 0), b3, voffB);
            PG8_BAR; PG8_WAIT_L(0); PG8_MMA(0, 1, At, B1); PG8_BAR;
            PG8_LDA(At, 1, 1); PG8_STAGE(PG8_SA(1, 0), a3, voffA);
            PG8_BAR; PG8_WAIT_L(0); PG8_MMA(1, 0, At, B0); PG8_BAR; PG8_SCHED;
            PG8_STAGE(PG8_SB(1, 1), b3 + hstep, voffB);
            PG8_WAIT_V(6); PG8_BAR; PG8_MMA(1, 1, At, B1); PG8_BAR;
            }
        }
        if constexpr (ALIGN_EPI) { if (wr == 0) PG8_BAR; }
        if constexpr (!Epi::AFTER_DRAIN) { E(acc, cur, wr, wc, fr, fq); S.done(cur); }
        if (!has_next) break;
#pragma unroll
        for (int a = 0; a < 2; ++a)
#pragma unroll
            for (int b = 0; b < 2; ++b)
#pragma unroll
                for (int m = 0; m < 4; ++m)
#pragma unroll
                    for (int n = 0; n < 2; ++n) acc[a][b][m][n] = (f32x4){0.f, 0.f, 0.f, 0.f};
        cur = nxt; cA = nA; cB = nB; ++ui;
        if constexpr (ALIGN_EPI) { if (wr == 1) PG8_BAR; }
    }
    PG8_WAIT_V(0);
    if constexpr (!ALIGN_EPI) { if (wr == 0) PG8_BAR; }
    PG8_BAR;
    if constexpr (Epi::AFTER_DRAIN) { E.fused(acc, cur, wr, wc, fr, fq, lds, wid, lane); S.done(cur); }
#undef PG8_SA
#undef PG8_SB
#undef PG8_STAGE
#undef PG8_LDA
#undef PG8_LDB
#undef PG8_MMA
#undef PG8_WAIT_V
#undef PG8_WAIT_L
#undef PG8_BAR
#undef PG8_SCHED
}
}
namespace att {
#define ATT_LAS __attribute__((address_space(3)))
typedef unsigned short bf16_t;
using bf16x8 = __attribute__((ext_vector_type(8))) short;
using s16x4 = __attribute__((ext_vector_type(4))) short;
using f32x16 = __attribute__((ext_vector_type(16))) float;
using f32x4 = __attribute__((ext_vector_type(4))) float;
using u32x4 = __attribute__((ext_vector_type(4))) unsigned;
typedef float f32x2_t __attribute__((ext_vector_type(2))); typedef __bf16 bf16x2_t __attribute__((ext_vector_type(2)));
typedef short v4i16_t __attribute__((ext_vector_type(4)));
constexpr int SEQ = 8192, PITCH = 2304;
constexpr int KW_OFF = 0, VW_OFF = 49152, WS_OFF = 98304, WS_STRIDE = 4608, LDS_BYTES = WS_OFF + 8 * WS_STRIDE;
constexpr float NEG = -1.0e30f, THR = 8.0f;
__device__ __forceinline__ int crow(int r, int hi) { return (r & 3) + 8 * (r >> 2) + 4 * hi; }
__device__ __forceinline__ unsigned cvtpk(float lo, float hi) { f32x2_t v = {lo, hi}; bf16x2_t b = __builtin_convertvector(v, bf16x2_t); return __builtin_bit_cast(unsigned, b); }
__device__ __forceinline__ s16x4 vtr(const ATT_LAS unsigned char* p) { return __builtin_bit_cast(s16x4, __builtin_amdgcn_ds_read_tr16_b64_v4i16((ATT_LAS v4i16_t*)p)); }
__device__ __forceinline__ float hmax(float v) { auto rr = __builtin_amdgcn_permlane32_swap(__float_as_uint(v), __float_as_uint(v), false, false); return fmaxf(__uint_as_float(rr[0]), __uint_as_float(rr[1])); }
__device__ __forceinline__ float hsum(float v) { auto rr = __builtin_amdgcn_permlane32_swap(__float_as_uint(v), __float_as_uint(v), false, false); return __uint_as_float(rr[0]) + __uint_as_float(rr[1]); }

struct UnitP {
    int isA;
    int b, dil, res;
    int L;
    int kw0;
    int nbw;
    int kcol, vcol;
    int pat;
    int hsel;
    int qblk0;
};

__device__ __forceinline__ void attn_unit(ATT_LAS unsigned char* lds, const UnitP U, const bf16_t* PJ, const float* sinkv, bf16_t* CAT, bf16_t* OPB, float* LSE) {
    int tid_ = threadIdx.x; asm volatile("" : "+v"(tid_));
    const int tid = tid_, lane = tid & 63, r32 = lane & 31, hi = lane >> 5; const int wid = __builtin_amdgcn_readfirstlane(tid >> 6);
    int qh, q0, jb0, nblk, qcol;
    if (U.isA) { qh = 4 * U.hsel + (wid & 3); q0 = U.qblk0 + 32 * (wid >> 2); jb0 = wid >> 2; nblk = 9; qcol = qh * 64; }
    else       { qh = U.hsel;                 q0 = U.qblk0 + 32 * wid;        jb0 = wid;      nblk = 5; qcol = 768 + qh * 64; }
    const long tok0 = (long)U.b * SEQ + U.res;
    {
        const bf16_t* src; unsigned dst;
        if (wid < 4) { const int kl = 8 * wid + (lane >> 3), cp = lane & 7, c = cp ^ ((kl >> 1) & 7);
            src = PJ + (tok0 + (long)(U.kw0 + kl) * U.dil) * PITCH + U.kcol + c * 8; dst = KW_OFF + wid * 1024; }
        else { const int pc = wid - 4, dh = pc >> 1, kg = pc & 1, kl = 16 * kg + (lane >> 2);
            src = PJ + (tok0 + (long)(U.kw0 + kl) * U.dil) * PITCH + U.vcol + dh * 32 + (lane & 3) * 8; dst = VW_OFF + pc * 1024; }
        const long bstep = (long)32 * U.dil * PITCH;
        for (int wb = 0; wb < U.nbw; ++wb) {
            const int kb = U.kw0 + 32 * wb;
            if (kb >= 0 && kb < U.L)
                __builtin_amdgcn_global_load_lds((const unsigned*)(src + wb * bstep), (ATT_LAS unsigned*)(lds + dst + wb * 4096), 16, 0, 0);
        }
    }
    bf16x8 qr[4];
    { const bf16_t* qp = PJ + (tok0 + (long)(q0 + r32) * U.dil) * PITCH + qcol + hi * 8;
#pragma unroll
      for (int st = 0; st < 4; ++st) qr[st] = *(const bf16x8*)(qp + st * 16); }
    ATT_LAS float* sc = (ATT_LAS float*)(lds + WS_OFF + wid * WS_STRIDE);
    ATT_LAS bf16_t* stg = (ATT_LAS bf16_t*)(lds + WS_OFF + wid * WS_STRIDE + 512);
    asm volatile("s_waitcnt vmcnt(0)" ::: "memory");
    __syncthreads();
    f32x16 o[2]; o[0] = f32x16{}; o[1] = f32x16{};
    float m = 0.f, l = 0.f; bool first = true;
    const int kx = (r32 >> 1) & 7;
    const ATT_LAS unsigned char* kbase = lds + KW_OFF + r32 * 128;
    const ATT_LAS unsigned char* vbase = lds + VW_OFF + ((lane >> 4) & 1) * 32 + (lane & 3) * 8 + (4 * hi + ((lane & 15) >> 2)) * 64;
    for (int jj = 0; jj < nblk; ++jj) {
        const int wb = jb0 + jj, kb = U.kw0 + 32 * wb;
        if (kb < 0 || kb >= U.L) continue;
        const ATT_LAS unsigned char* kp = kbase + wb * 4096;
        f32x16 s = f32x16{};
#pragma unroll
        for (int st = 0; st < 4; ++st) {
            const bf16x8 kf = *(const ATT_LAS bf16x8*)(kp + (((2 * st + hi) ^ kx) << 4));
            s = __builtin_amdgcn_mfma_f32_32x32x16_bf16(kf, qr[st], s, 0, 0, 0);
        }
        if (jj == 0) {
#pragma unroll
            for (int r = 0; r < 16; ++r) s[r] = (crow(r, hi) >= r32) ? s[r] : NEG;
        } else if (jj == nblk - 1) {
#pragma unroll
            for (int r = 0; r < 16; ++r) s[r] = (crow(r, hi) <= r32) ? s[r] : NEG;
        }
        float mx = s[0];
#pragma unroll
        for (int r = 1; r < 16; ++r) mx = fmaxf(mx, s[r]);
        mx = hmax(mx);
        if (first) { m = mx; first = false; }
        else if (__any(mx > m + THR)) {
            const float mn = fmaxf(m, mx), alpha = __builtin_amdgcn_exp2f(m - mn);
            l *= alpha; m = mn;
            if (hi == 0) sc[r32] = alpha;
            asm volatile("s_waitcnt lgkmcnt(0)" ::: "memory");
#pragma unroll
            for (int g = 0; g < 4; ++g) { const f32x4 a4 = *(const ATT_LAS f32x4*)(sc + 8 * g + 4 * hi);
#pragma unroll
                for (int e = 0; e < 4; ++e) { o[0][4 * g + e] *= a4[e]; o[1][4 * g + e] *= a4[e]; } }
            asm volatile("s_waitcnt lgkmcnt(0)" ::: "memory");
        }
        float ps = 0.f;
#pragma unroll
        for (int r = 0; r < 16; ++r) { s[r] = __builtin_amdgcn_exp2f(s[r] - m); ps += s[r]; }
        l += ps;
        u32x4 pw0, pw1;
        pw0.x = cvtpk(s[0], s[1]); pw0.y = cvtpk(s[2], s[3]); pw0.z = cvtpk(s[4], s[5]); pw0.w = cvtpk(s[6], s[7]);
        pw1.x = cvtpk(s[8], s[9]); pw1.y = cvtpk(s[10], s[11]); pw1.z = cvtpk(s[12], s[13]); pw1.w = cvtpk(s[14], s[15]);
        const ATT_LAS unsigned char* vp = vbase + wb * 4096;
#pragma unroll
        for (int d0 = 0; d0 < 2; ++d0) {
            const s16x4 l0 = vtr(vp + (d0 * 2 + 0) * 1024), h0 = vtr(vp + (d0 * 2 + 0) * 1024 + 512);
            const s16x4 l1 = vtr(vp + (d0 * 2 + 1) * 1024), h1 = vtr(vp + (d0 * 2 + 1) * 1024 + 512);
            const bf16x8 v0 = (bf16x8){l0[0], l0[1], l0[2], l0[3], h0[0], h0[1], h0[2], h0[3]};
            const bf16x8 v1 = (bf16x8){l1[0], l1[1], l1[2], l1[3], h1[0], h1[1], h1[2], h1[3]};
            o[d0] = __builtin_amdgcn_mfma_f32_32x32x16_bf16(__builtin_bit_cast(bf16x8, pw0), v0, o[d0], 0, 0, 0);
            o[d0] = __builtin_amdgcn_mfma_f32_32x32x16_bf16(__builtin_bit_cast(bf16x8, pw1), v1, o[d0], 0, 0, 0);
        }
    }
    float lt = hsum(l), fac;
    if (U.isA) { const float sk = sinkv[qh] * 1.4426950408889634f; const float m2 = fmaxf(m, sk), a = __builtin_amdgcn_exp2f(m - m2);
        lt = lt * a + __builtin_amdgcn_exp2f(sk - m2); fac = a / lt; }
    else { fac = 1.0f / lt; }
    if (hi == 0) sc[r32] = fac;
    asm volatile("s_waitcnt lgkmcnt(0)" ::: "memory");
#pragma unroll
    for (int g = 0; g < 4; ++g) { const f32x4 a4 = *(const ATT_LAS f32x4*)(sc + 8 * g + 4 * hi);
#pragma unroll
        for (int e = 0; e < 4; ++e) { const int r = 4 * g + e, orow = crow(r, hi);
            stg[orow * 64 + r32] = (bf16_t)(cvtpk(o[0][r] * a4[e], 0.f) & 0xffffu);
            stg[orow * 64 + 32 + r32] = (bf16_t)(cvtpk(o[1][r] * a4[e], 0.f) & 0xffffu); } }
    asm volatile("s_waitcnt lgkmcnt(0)" ::: "memory");
    {
        bf16_t* ob; int opitch;
        if (U.isA) { ob = CAT + qh * 64; opitch = 1024; } else { ob = OPB + (size_t)U.pat * ((size_t)4 * SEQ * 512) + qh * 64; opitch = 512; }
#pragma unroll
        for (int i = 0; i < 4; ++i) { const int row = i * 8 + (lane >> 3), ch = lane & 7;
            const u32x4 v = *(const ATT_LAS u32x4*)(stg + row * 64 + ch * 8);
            *(u32x4*)(ob + (size_t)(tok0 + (long)(q0 + row) * U.dil) * opitch + ch * 8) = v; }
        if (!U.isA && hi == 0) LSE[((size_t)U.pat * 4 * SEQ + (size_t)(tok0 + (long)(q0 + r32) * U.dil)) * 8 + qh] = m + __builtin_amdgcn_logf(lt);
    }
    asm volatile("s_waitcnt lgkmcnt(0)" ::: "memory");
    __syncthreads();
}
#undef ATT_LAS
}

constexpr int NWAVES = 8;
constexpr int BATCH = 4, SEQ = 8192, D = 1024, T = BATCH * SEQ, FF = 2816, NGU = 2 * FF, INW = 2304;
constexpr float QSCALE = 0.125f * 1.4426950408889634f;
constexpr size_t MiB = 1u << 20;
constexpr size_t WS_CTL = 0, CTL_ZERO_BYTES = 1 * MiB;
constexpr size_t WS_WGU1 = 2 * MiB, WS_WD1 = 13 * MiB, WS_WIN = 19 * MiB, WS_WOUT = 24 * MiB, WS_WGU2 = 26 * MiB, WS_WD2 = 37 * MiB;
constexpr size_t WS_COS = 44 * MiB, WS_SIN = 48 * MiB;
constexpr size_t WS_SSQ0 = 52 * MiB, WS_SSQ1 = 54 * MiB, WS_SSQ2 = 56 * MiB;
constexpr size_t WS_LSE = 58 * MiB;
constexpr size_t WS_XB = 64 * MiB;
constexpr size_t WS_CAT = 128 * MiB;
constexpr size_t WS_H = 192 * MiB;
constexpr size_t WS_PJ = 192 * MiB;
constexpr size_t WS_OPB = 368 * MiB;
constexpr size_t WS_END = 464 * MiB;
static_assert(WS_WGU1 + (size_t)NGU * D * 2 <= WS_WD1 && WS_WD1 + (size_t)D * FF * 2 <= WS_WIN && WS_WIN + (size_t)INW * D * 2 <= WS_WOUT && WS_WOUT + (size_t)D * D * 2 <= WS_WGU2 &&
              WS_WGU2 + (size_t)NGU * D * 2 <= WS_WD2 && WS_WD2 + (size_t)D * FF * 2 <= WS_COS && WS_LSE + (size_t)3 * T * 8 * 4 <= WS_XB && WS_H + (size_t)T * FF * 2 <= WS_OPB && WS_OPB + (size_t)3 * T * 512 * 2 <= WS_END, "d_ws map");
constexpr int CW_BAR = 4096;
constexpr int RING_OFF = 0, RING_BYTES = 131072;
constexpr int LDSCTL_OFF = 139264, MISC_OFF = LDSCTL_OFF + 320;
constexpr int LDS_BYTES = 147456;
static_assert(att::LDS_BYTES <= LDSCTL_OFF && MISC_OFF + 128 <= LDS_BYTES, "LDS map");

#define GAS __attribute__((address_space(1)))
#define LAS __attribute__((address_space(3)))
typedef unsigned short bf16;
typedef unsigned v4u __attribute__((ext_vector_type(4)));
typedef float f32x4 __attribute__((ext_vector_type(4)));
typedef short bf16x8 __attribute__((ext_vector_type(8)));
typedef GAS unsigned gu32;
typedef GAS unsigned long long gu64;
#define RLX_AGENT __ATOMIC_RELAXED, __HIP_MEMORY_SCOPE_AGENT
#define LDS_WAIT() asm volatile("s_waitcnt lgkmcnt(0)" ::: "memory")
#define VM_WAIT() asm volatile("s_waitcnt vmcnt(0)" ::: "memory")
__device__ __forceinline__ unsigned long long rt() { return __builtin_amdgcn_s_memrealtime(); }
__device__ __forceinline__ unsigned f2bf(float f) { unsigned u = __builtin_bit_cast(unsigned, f); return (u + 0x7fffu + ((u >> 16) & 1u)) >> 16; }
__device__ __forceinline__ unsigned pk2(float lo, float hi) { return f2bf(lo) | (f2bf(hi) << 16); }

#define XB_TMO      128
#define XB_XCNT(j)  (256  + 64 * (j))
#define XB_XSUB(j)  (1280 + 64 * (j))
#define XB_XGEN(j)  (2304 + 64 * (j))
#define XB_TOP      3328
#define XB_TOPGEN   3392
#define XCD_BAR_WORDS 3456
#define XB_SPIN_CAP (1u << 18)

__device__ __forceinline__ unsigned xb_ld(unsigned* p)              { return __hip_atomic_load(p, __ATOMIC_RELAXED, __HIP_MEMORY_SCOPE_AGENT); }
__device__ __forceinline__ unsigned xb_add(unsigned* p, unsigned v) { return __hip_atomic_fetch_add(p, v, __ATOMIC_RELAXED, __HIP_MEMORY_SCOPE_AGENT); }
__device__ __forceinline__ unsigned xb_xcc_id() { return (unsigned)__builtin_amdgcn_s_getreg((3 << 11) | 20) & 0xFu; }
#define XB_SPIN(cond, bar) do { unsigned _sp = 0; while (cond) { __builtin_amdgcn_s_sleep(1); \
    if ((++_sp & 255u) == 0u) { if (xb_ld(&(bar)[XB_TMO])) break; if (_sp > XB_SPIN_CAP) { atomicAdd(&(bar)[XB_TMO], 1u); break; } } } } while (0)

struct XcdBarrier {
    unsigned* bar; unsigned x;
    volatile LAS unsigned* st;
};

__device__ __forceinline__ XcdBarrier xcd_barrier_post(unsigned* bar, volatile LAS unsigned* st) {
    XcdBarrier b; b.bar = bar; b.x = xb_xcc_id(); b.st = st;
    if (threadIdx.x == 0) (void)xb_add(&bar[XB_XCNT(b.x)], 1u);
    return b;
}
__device__ __forceinline__ void xcd_barrier_complete(unsigned* bar, unsigned x, unsigned& nloc, unsigned& nx) {
    const unsigned G = gridDim.x * gridDim.y * gridDim.z;
    unsigned sum, cnt, mine, sp = 0u;
    for (;;) {
        sum = 0u; cnt = 0u; mine = 0u;
#pragma unroll
        for (unsigned j = 0; j < 16; ++j) { const unsigned c = xb_ld(&bar[XB_XCNT(j)]); sum += c; cnt += (c > 0u) ? 1u : 0u; mine = (j == x) ? c : mine; }
        if (sum == G) break;
        __builtin_amdgcn_s_sleep(1);
        if ((++sp & 255u) == 0u) { if (xb_ld(&bar[XB_TMO])) break; if (sp > XB_SPIN_CAP) { atomicAdd(&bar[XB_TMO], 1u); break; } }
    }
    nloc = mine > 0u ? mine : 1u; nx = cnt > 0u ? cnt : 1u;
}

__device__ __forceinline__ void xcd_barrier(const XcdBarrier& b) {
    asm volatile("s_waitcnt vmcnt(0)" ::: "memory");
    __syncthreads();
    if (threadIdx.x == 0) {
        unsigned* bar = b.bar;
        __builtin_amdgcn_s_waitcnt(0);
        unsigned nloc = b.st[0], nx = b.st[1];
        if (nloc == 0u) { xcd_barrier_complete(bar, b.x, nloc, nx); b.st[0] = nloc; b.st[1] = nx; }
        const unsigned old = xb_add(&bar[XB_XSUB(b.x)], 1u);
        const unsigned gen = old / nloc;
        if (old + 1u == (gen + 1u) * nloc) {
            __builtin_amdgcn_fence(__ATOMIC_RELEASE, "agent");
            asm volatile("s_waitcnt vmcnt(0)" ::: "memory");
            const unsigned og = xb_add(&bar[XB_TOP], 1u);
            const unsigned tg = og / nx;
            if (og + 1u == (tg + 1u) * nx) xb_add(&bar[XB_TOPGEN], 1u);
            else XB_SPIN(xb_ld(&bar[XB_TOPGEN]) == tg, bar);
            __builtin_amdgcn_fence(__ATOMIC_ACQUIRE, "agent");
            xb_add(&bar[XB_XGEN(b.x)], 1u);
            asm volatile("s_waitcnt vmcnt(0)" ::: "memory");
        } else {
            XB_SPIN(xb_ld(&bar[XB_XGEN(b.x)]) == gen, bar);
            __builtin_amdgcn_fence(__ATOMIC_ACQUIRE, "agent");
            asm volatile("s_waitcnt vmcnt(0)" ::: "memory");
        }
    }
    __syncthreads();
}
struct Frame {
    LAS unsigned char* lds;
    volatile LAS unsigned* MISC;
    gu32* ctl;
    int tid, lane, wave;
    int vcu, G;
};
__device__ __forceinline__ float wave_sum(float v) {
#pragma unroll
    for (int o = 1; o < 64; o <<= 1) v += __shfl_xor(v, o);
    return v;
}
__device__ __forceinline__ void p0_transpose_item(const float* W, int N, bf16* WT, int Kd, int drow0, const float* gain, LAS float* scr, int k0, int n0, int lane) {
#pragma unroll 8
    for (int i = 0; i < 32; ++i) { const int kk = 2 * i + (lane >> 5); float v = W[(size_t)(k0 + kk) * N + n0 + (lane & 31)]; if (gain) v *= gain[k0 + kk]; scr[kk * 33 + (lane & 31)] = v; }
    LDS_WAIT(); asm volatile("" ::: "memory");
    const int c = lane & 7;
#pragma unroll
    for (int j = 0; j < 4; ++j) { const int n = (lane >> 3) + 8 * j; const LAS float* s = scr + (8 * c) * 33 + n;
        v4u o; o.x = pk2(s[0 * 33], s[1 * 33]); o.y = pk2(s[2 * 33], s[3 * 33]); o.z = pk2(s[4 * 33], s[5 * 33]); o.w = pk2(s[6 * 33], s[7 * 33]);
        *(GAS v4u*)(WT + (size_t)(drow0 + n) * Kd + k0 + 8 * c) = o; }
    LDS_WAIT(); asm volatile("" ::: "memory");
}
struct Args { const float* in[15]; float* out; unsigned char* ws; };
__device__ const float inv_freq_tab[32] = {
    0x1.000000p+0f, 0x1.7ff222p-1f, 0x1.1feb34p-1f, 0x1.afd136p-2f, 0x1.43d136p-2f, 0x1.e5a84ap-3f, 0x1.6c310ep-3f, 0x1.111aeep-3f, 0x1.99999ap-4f, 0x1.33281ap-4f, 0x1.ccab84p-5f, 0x1.59742ap-5f, 0x1.030dc6p-5f, 0x1.84869ep-6f, 0x1.235a72p-6f, 0x1.b4f7e4p-7f,
    0x1.47ae14p-7f, 0x1.eb7360p-8f, 0x1.708938p-8f, 0x1.145ceep-8f, 0x1.9e7c70p-9f, 0x1.36d21ap-9f, 0x1.d22a50p-10f, 0x1.5d931cp-10f, 0x1.0624dep-10f, 0x1.892918p-11f, 0x1.26d42cp-11f, 0x1.ba2e4ep-12f, 0x1.4b96c0p-12f, 0x1.f1502ap-13f, 0x1.74eea6p-13f, 0x1.17a8e4p-13f};

__device__ __forceinline__ void p0_prologue(Frame& F, const Args& A) {
    unsigned char* ws = A.ws;
    LAS float* scr = (LAS float*)(F.lds + RING_OFF + F.wave * 16384);
    const int gw = F.vcu * NWAVES + F.wave, NGW = F.G * NWAVES;
    constexpr int I_GU = (D / 64) * (FF / 32), I_DN = (FF / 64) * (D / 32), I_IN = (D / 64) * (INW / 32), I_OUT = (D / 64) * (D / 32);
    constexpr int NITEMS = 4 * I_GU + 2 * I_DN + I_IN + I_OUT;
    for (int it = gw; it < NITEMS; it += NGW) {
        int r = it;
        if (r < 4 * I_GU) {
            const int mat = r / I_GU; r -= mat * I_GU; const int nblk = FF / 32, kb = r / nblk, nb = r % nblk, n0 = 32 * nb;
            const int layer2 = mat >> 1, isup = mat & 1;
            const float* W = A.in[(layer2 ? 11 : 3) + isup]; const float* gain = A.in[layer2 ? 10 : 2];
            bf16* WT = (bf16*)(ws + (layer2 ? WS_WGU2 : WS_WGU1));
            p0_transpose_item(W, FF, WT, D, 256 * (n0 >> 7) + 128 * isup + (n0 & 127), gain, scr, 64 * kb, n0, F.lane); continue; }
        r -= 4 * I_GU;
        if (r < 2 * I_DN) { const int layer2 = r / I_DN; r -= layer2 * I_DN; const int nblk = D / 32, kb = r / nblk, nb = r % nblk;
            p0_transpose_item(A.in[layer2 ? 13 : 5], D, (bf16*)(ws + (layer2 ? WS_WD2 : WS_WD1)), FF, 32 * nb, nullptr, scr, 64 * kb, 32 * nb, F.lane); continue; }
        r -= 2 * I_DN;
        if (r < I_IN) { const int nblk = INW / 32, kb = r / nblk, nb = r % nblk, c = 32 * nb;
            p0_transpose_item(A.in[7], INW, (bf16*)(ws + WS_WIN), D, 256 * (c >> 8) + 128 * ((c & 63) >> 5) + 32 * ((c & 255) >> 6), A.in[6], scr, 64 * kb, c, F.lane); continue; }
        r -= I_IN;
        { const int nblk = D / 32, kb = r / nblk, nb = r % nblk;
            p0_transpose_item(A.in[9], D, (bf16*)(ws + WS_WOUT), D, 32 * nb, nullptr, scr, 64 * kb, 32 * nb, F.lane); }
    }
    { const float* x = A.in[0]; bf16* XB = (bf16*)(ws + WS_XB); float* SSQ = (float*)(ws + WS_SSQ0);
      for (int mrow = gw; mrow < T; mrow += NGW) {
          const GAS f32x4* xr = (const GAS f32x4*)(x + (size_t)mrow * D) + F.lane;
          f32x4 v[4]; float s = 0.f;
#pragma unroll
          for (int j = 0; j < 4; ++j) { v[j] = xr[64 * j]; s += (v[j].x * v[j].x + v[j].y * v[j].y) + (v[j].z * v[j].z + v[j].w * v[j].w); }
          s = wave_sum(s);
          GAS unsigned long long* o8 = (GAS unsigned long long*)(XB + (size_t)mrow * D) + F.lane;
#pragma unroll
          for (int j = 0; j < 4; ++j) o8[64 * j] = (unsigned long long)pk2(v[j].x, v[j].y) | ((unsigned long long)pk2(v[j].z, v[j].w) << 32);
          if (F.lane < 16) SSQ[(size_t)mrow * 16 + F.lane] = (F.lane == 0) ? s : 0.f;
      } }
    { const int* pos = (const int*)A.in[1]; float* COS = (float*)(ws + WS_COS); float* SIN = (float*)(ws + WS_SIN);
      const int gt = (F.vcu * NWAVES + F.wave) * 64 + F.lane, NGT = NGW * 64;
      for (int idx = gt; idx < T * 32; idx += NGT) { const float ang = (float)pos[idx >> 5] * inv_freq_tab[idx & 31]; float sn, cs; sincosf(ang, &sn, &cs); COS[idx] = cs; SIN[idx] = sn; } }
}

__global__ void __launch_bounds__(NWAVES * 64, 2) mega_fwd(Args args) {
    extern __shared__ __attribute__((aligned(16))) unsigned char lds[];
    Frame F;
    F.lds = (LAS unsigned char*)lds;
    F.MISC = (volatile LAS unsigned*)(F.lds + MISC_OFF);
    F.tid = threadIdx.x; F.lane = F.tid & 63; F.wave = __builtin_amdgcn_readfirstlane(F.tid >> 6);
    F.G = gridDim.x; { const int bx = blockIdx.x; F.vcu = (F.G % 8 == 0) ? (bx % 8) * (F.G / 8) + bx / 8 : bx; }
    unsigned char* ws = args.ws;
    F.ctl = (gu32*)(ws + WS_CTL);
    for (int u = F.tid; u < (LDS_BYTES - LDSCTL_OFF) / 4; u += NWAVES * 64) ((LAS unsigned*)(F.lds + LDSCTL_OFF))[u] = 0u;
    __syncthreads();
    XcdBarrier bar = xcd_barrier_post((unsigned*)(F.ctl + CW_BAR), F.MISC + 8);
#define GRID_BAR() xcd_barrier(bar)
    float* out = args.out;
    bf16* XB = (bf16*)(ws + WS_XB); bf16* CATB = (bf16*)(ws + WS_CAT); bf16* HB = (bf16*)(ws + WS_H); bf16* PJ = (bf16*)(ws + WS_PJ); bf16* OPB = (bf16*)(ws + WS_OPB);
    float* SSQ0 = (float*)(ws + WS_SSQ0); float* SSQ1 = (float*)(ws + WS_SSQ1); float* SSQ2 = (float*)(ws + WS_SSQ2); float* LSE = (float*)(ws + WS_LSE);

    p0_prologue(F, args);
    GRID_BAR();
    { pg8::Gemm g{XB, (const bf16*)(ws + WS_WGU1), T, NGU, D}; pg8::StaticOrder S; S.init(T, NGU, F.G, (int)blockIdx.x);
      pg8::EpiSwiglu E{HB, SSQ0, FF};
      pg8::gemm_phase<pg8::EpiSwiglu, pg8::StaticOrder, true, true>(F.lds + RING_OFF, g, S, E); }
    GRID_BAR();
    { pg8::Gemm g{HB, (const bf16*)(ws + WS_WD1), T, D, FF}; pg8::StaticOrder S; S.init(T, D, F.G, (int)blockIdx.x);
      pg8::EpiRes<true, true> E{args.in[0], out, XB, SSQ1, 0.5f};
      pg8::gemm_phase<pg8::EpiRes<true, true>, pg8::StaticOrder, true, true>(F.lds + RING_OFF, g, S, E); }
    GRID_BAR();
    { pg8::Gemm g{XB, (const bf16*)(ws + WS_WIN), T, INW, D}; pg8::StaticOrder S; S.init(T, INW, F.G, (int)blockIdx.x);
      pg8::EpiQkv E{PJ, SSQ1, (const float*)(ws + WS_COS), (const float*)(ws + WS_SIN), QSCALE, INW};
      pg8::gemm_phase<pg8::EpiQkv, pg8::StaticOrder, true, true>(F.lds + RING_OFF, g, S, E); }
    GRID_BAR();
    for (int u = F.vcu; u < 4096; u += F.G) {
        att::UnitP U;
        if (u < 1024) { const int b = u >> 8, kvh = (u >> 7) & 1, blk = u & 127;
            U.isA = 1; U.b = b; U.dil = 1; U.res = 0; U.L = SEQ; U.kw0 = 64 * blk - 128; U.nbw = 10; U.kcol = 512 + kvh * 64; U.vcol = 640 + kvh * 64; U.pat = 0; U.hsel = kvh; U.qblk0 = 64 * blk; }
        else { const int ub = u - 1024, b = ub / 768, r = ub % 768, hb = r / 96, r2 = r % 96, p = r2 >> 5, w = r2 & 31;
            const int dil = p == 0 ? 1 : (p == 1 ? 4 : 16), res = p == 0 ? 0 : (p == 1 ? (w >> 3) : (w >> 1)), sblk = p == 0 ? w : (p == 1 ? (w & 7) : (w & 1));
            U.isA = 0; U.b = b; U.dil = dil; U.res = res; U.L = SEQ / dil; U.kw0 = 256 * sblk - 64; U.nbw = 12; U.kcol = 1280 + hb * 64; U.vcol = 1792 + hb * 64; U.pat = p; U.hsel = hb; U.qblk0 = 256 * sblk; }
        att::attn_unit(F.lds + RING_OFF, U, PJ, args.in[8], CATB, OPB, LSE);
    }
    GRID_BAR();
    { const int gt = (F.vcu * NWAVES + F.wave) * 64 + F.lane, NGT = F.G * NWAVES * 64;
      for (int idx = gt; idx < T * 64; idx += NGT) {
          const int tok = idx >> 6, hb = (idx >> 3) & 7, ch = idx & 7;
          const float l0 = LSE[((size_t)0 * T + tok) * 8 + hb], l1 = LSE[((size_t)1 * T + tok) * 8 + hb], l2 = LSE[((size_t)2 * T + tok) * 8 + hb];
          const float mx = fmaxf(l0, fmaxf(l1, l2));
          float w0 = __builtin_amdgcn_exp2f(l0 - mx), w1 = __builtin_amdgcn_exp2f(l1 - mx), w2 = __builtin_amdgcn_exp2f(l2 - mx);
          const float inv = 1.0f / (w0 + w1 + w2); w0 *= inv; w1 *= inv; w2 *= inv;
          const size_t off = (size_t)tok * 512 + hb * 64 + ch * 8;
          const v4u a = *(const v4u*)(OPB + off), b = *(const v4u*)(OPB + (size_t)T * 512 + off), c = *(const v4u*)(OPB + (size_t)2 * T * 512 + off);
          v4u o;
#pragma unroll
          for (int k = 0; k < 4; ++k) {
              const float alo = __uint_as_float(a[k] << 16), ahi = __uint_as_float(a[k] & 0xffff0000u);
              const float blo = __uint_as_float(b[k] << 16), bhi = __uint_as_float(b[k] & 0xffff0000u);
              const float clo = __uint_as_float(c[k] << 16), chi = __uint_as_float(c[k] & 0xffff0000u);
              o[k] = pk2(w0 * alo + w1 * blo + w2 * clo, w0 * ahi + w1 * bhi + w2 * chi); }
          *(v4u*)(CATB + (size_t)tok * 1024 + 512 + hb * 64 + ch * 8) = o;
      } }
    GRID_BAR();
    { pg8::Gemm g{CATB, (const bf16*)(ws + WS_WOUT), T, D, D}; pg8::StaticOrder S; S.init(T, D, F.G, (int)blockIdx.x);
      pg8::EpiRes<true, true> E{out, out, XB, SSQ2, 1.0f};
      pg8::gemm_phase<pg8::EpiRes<true, true>, pg8::StaticOrder, true, true>(F.lds + RING_OFF, g, S, E); }
    GRID_BAR();
    { pg8::Gemm g{XB, (const bf16*)(ws + WS_WGU2), T, NGU, D}; pg8::StaticOrder S; S.init(T, NGU, F.G, (int)blockIdx.x);
      pg8::EpiSwiglu E{HB, SSQ2, FF};
      pg8::gemm_phase<pg8::EpiSwiglu, pg8::StaticOrder, true, true>(F.lds + RING_OFF, g, S, E); }
    GRID_BAR();
    { pg8::Gemm g{HB, (const bf16*)(ws + WS_WD2), T, D, FF}; pg8::StaticOrder S; S.init(T, D, F.G, (int)blockIdx.x);
      pg8::EpiRes<false, false> E{out, out, nullptr, nullptr, 0.5f};
      pg8::gemm_phase<pg8::EpiRes<false, false>, pg8::StaticOrder, true, true>(F.lds + RING_OFF, g, S, E); }
    GRID_BAR();
    { const float* gf = args.in[14]; const int gw = F.vcu * NWAVES + F.wave, NGW = F.G * NWAVES;
      f32x4 gv[4];
#pragma unroll
      for (int j = 0; j < 4; ++j) gv[j] = *((const f32x4*)gf + F.lane + 64 * j);
      for (int mrow = gw; mrow < T; mrow += NGW) {
          GAS f32x4* xr = (GAS f32x4*)(out + (size_t)mrow * D) + F.lane;
          f32x4 v[4]; float s = 0.f;
#pragma unroll
          for (int j = 0; j < 4; ++j) { v[j] = xr[64 * j]; s += (v[j].x * v[j].x + v[j].y * v[j].y) + (v[j].z * v[j].z + v[j].w * v[j].w); }
          const float rs = 1.0f / sqrtf(wave_sum(s) * (1.0f / D) + 1e-6f);
#pragma unroll
          for (int j = 0; j < 4; ++j) xr[64 * j] = v[j] * rs * gv[j];
      } }
#undef GRID_BAR
}

extern "C" void kernel_launch(void* const* d_in, const int* in_sizes, int n_in, void* d_out, int out_size, void* d_ws, size_t ws_size, hipStream_t stream) {
    static int grid = 0;
    if (grid == 0) {
        if (n_in != 15 || in_sizes[0] != T * D || out_size != T * D || ws_size < WS_END) { fprintf(stderr, "kernel_launch: unexpected shapes (n_in %d, in0 %d, out %d, ws %zu); nothing launched\n", n_in, n_in > 0 ? in_sizes[0] : -1, out_size, ws_size); grid = -1; return; }
        int dev = 0, cus = 0, per_cu = 0;
        if (hipGetDevice(&dev) != hipSuccess || hipDeviceGetAttribute(&cus, hipDeviceAttributeMultiprocessorCount, dev) != hipSuccess) { fprintf(stderr, "kernel_launch: device query failed\n"); grid = -1; return; }
        if (hipFuncSetAttribute((const void*)mega_fwd, hipFuncAttributeMaxDynamicSharedMemorySize, LDS_BYTES) != hipSuccess) { fprintf(stderr, "kernel_launch: hipFuncSetAttribute failed\n"); grid = -1; return; }
        if (hipOccupancyMaxActiveBlocksPerMultiprocessor(&per_cu, (const void*)mega_fwd, NWAVES * 64, LDS_BYTES) != hipSuccess || per_cu < 1)
            fprintf(stderr, "kernel_launch: note: occupancy query reports %d workgroups per CU\n", per_cu);
        (void)hipGetLastError();
        grid = cus;
    }
    if (grid < 0) return;
    if (hipMemsetAsync((char*)d_ws + WS_CTL, 0, CTL_ZERO_BYTES, stream) != hipSuccess) { fprintf(stderr, "kernel_launch: hipMemsetAsync failed\n"); return; }
    Args a{};
    for (int i = 0; i < 15; ++i) a.in[i] = (const float*)d_in[i];
    a.out = (float*)d_out; a.ws = (unsigned char*)d_ws;
    hipLaunchKernelGGL(mega_fwd, dim3(grid), dim3(NWAVES * 64), LDS_BYTES, stream, a);
    const hipError_t le = hipPeekAtLastError();
    if (le != hipSuccess) fprintf(stderr, "kernel_launch: launch failed: %s\n", hipGetErrorName(le));
}
```
